# Optimizing an MI355X kernel written in HIP

```python
import jax, jax.numpy as jnp
from jax import lax
import numpy as np

D_MODEL = 1024
BATCH = 1
SEQ = 16384
DEPTH = 1
DEC_BATCH = 32
DEC_SEQ = 32
PAST_LEN = 1024

CHUNK = 64
WINDOW = 128
WINDOW_CHUNKS = WINDOW // CHUNK
N_HEADS = 8
N_KV_HEADS = 2
HEAD_DIM = 64
GROUP = N_HEADS // N_KV_HEADS
ATTN_DIM = N_HEADS * HEAD_DIM
KV_DIM = N_KV_HEADS * HEAD_DIM
CONV_DIM = 512
CONV_WIDTH = 3
PLE_DIM = 256
ROPE_THETA = 10000.0
EPS = 1e-6
NEG = -1e30
SPLIT_SIZES = (ATTN_DIM, KV_DIM, KV_DIM, ATTN_DIM, CONV_DIM, CONV_DIM, CONV_DIM, CONV_DIM, D_MODEL, D_MODEL)
IN_DIM = 2 * ATTN_DIM + 2 * KV_DIM + 4 * CONV_DIM + 2 * D_MODEL

kernel_name = "hybrid_swa_sink_shortconv_stream_step"


def rmsnorm(x, g):
    xf = x.astype(jnp.float32)
    y = xf * lax.rsqrt(jnp.mean(xf * xf, axis=-1, keepdims=True) + EPS)
    return (y * g.astype(jnp.float32)).astype(x.dtype)


def rope(x, pos):
    half = HEAD_DIM // 2
    inv_freq = ROPE_THETA ** (-jnp.arange(0, half, dtype=jnp.float32) * 2.0 / HEAD_DIM)
    ang = pos[:, None] * inv_freq[None, :]
    cos = jnp.cos(ang)[None, :, None, :]
    sin = jnp.sin(ang)[None, :, None, :]
    xf = x.astype(jnp.float32)
    x1, x2 = xf[..., :half], xf[..., half:]
    return jnp.concatenate([x1 * cos - x2 * sin, x2 * cos + x1 * sin], axis=-1).astype(x.dtype)


def sink_softmax(s, mask, sink):
    s = jnp.where(mask, s, NEG)
    m = jnp.maximum(jnp.max(s, axis=-1, keepdims=True), sink)
    e = jnp.exp(s - m)
    return e / (jnp.sum(e, axis=-1, keepdims=True) + jnp.exp(sink - m))


def attend_prompt(q, k, v, sink):
    b, t = q.shape[0], q.shape[1]
    nc = t // CHUNK
    nb = WINDOW_CHUNKS + 1
    scale = HEAD_DIM ** -0.5
    qc = q.reshape(b, nc, CHUNK, N_KV_HEADS, GROUP, HEAD_DIM) * scale
    pad = ((0, 0), (WINDOW_CHUNKS, 0), (0, 0), (0, 0), (0, 0))
    kp = jnp.pad(k.reshape(b, nc, CHUNK, N_KV_HEADS, HEAD_DIM), pad)
    vp = jnp.pad(v.reshape(b, nc, CHUNK, N_KV_HEADS, HEAD_DIM), pad)
    kb = jnp.concatenate([kp[:, j:j + nc] for j in range(nb)], axis=2)
    vb = jnp.concatenate([vp[:, j:j + nc] for j in range(nb)], axis=2)
    key_chunk = jnp.arange(nc)[:, None] - WINDOW_CHUNKS + (jnp.arange(nb * CHUNK) // CHUNK)[None, :]
    mask = (key_chunk >= 0)[None, :, None, None, None, :]
    s = jnp.einsum('bncvgd,bnjvd->bnvgcj', qc, kb, preferred_element_type=jnp.float32)
    pr = sink_softmax(s, mask, sink.astype(jnp.float32).reshape(N_KV_HEADS, GROUP, 1, 1))
    o = jnp.einsum('bnvgcj,bnjvd->bncvgd', pr.astype(v.dtype), vb)
    return o.reshape(b, t, ATTN_DIM), k[:, -WINDOW:], v[:, -WINDOW:]


def attend_sample(q, k, v, sink, cache_k, cache_v):
    b, t = q.shape[0], q.shape[1]
    L = cache_k.shape[1]
    scale = HEAD_DIM ** -0.5
    kk = jnp.concatenate([cache_k, k], axis=1)
    vv = jnp.concatenate([cache_v, v], axis=1)
    q_pos = PAST_LEN + jnp.arange(t)
    k_pos = jnp.concatenate([PAST_LEN - L + jnp.arange(L), q_pos])
    qch = (q_pos // CHUNK)[:, None]
    kch = (k_pos // CHUNK)[None, :]
    mask = ((kch <= qch) & (kch >= qch - WINDOW_CHUNKS))[None, None, None]
    qg = q.reshape(b, t, N_KV_HEADS, GROUP, HEAD_DIM) * scale
    s = jnp.einsum('btvgd,bjvd->bvgtj', qg, kk, preferred_element_type=jnp.float32)
    pr = sink_softmax(s, mask, sink.astype(jnp.float32).reshape(N_KV_HEADS, GROUP, 1, 1))
    o = jnp.einsum('bvgtj,bjvd->btvgd', pr.astype(vv.dtype), vv)
    return o.reshape(b, t, ATTN_DIM), kk[:, -L:], vv[:, -L:]


def hybrid_layer(x, p, pos, conv_past, attend, ln_g, w_in, q_norm_g, k_norm_g, sink, conv_w,
                 w_attn_out, w_conv_out, w_o, w_ple_gate, w_ple_proj):
    b, t, _ = x.shape
    h = rmsnorm(x, ln_g)
    split_idx = np.cumsum(SPLIT_SIZES)[:-1].tolist()
    (q, k, v, gate_a, b_gate, c_gate, u_in, gate_c, merge_a, merge_c) = jnp.split(h @ w_in, split_idx, axis=-1)
    q = rope(rmsnorm(q.reshape(b, t, N_HEADS, HEAD_DIM), q_norm_g), pos)
    k = rope(rmsnorm(k.reshape(b, t, N_KV_HEADS, HEAD_DIM), k_norm_g), pos)
    v = v.reshape(b, t, N_KV_HEADS, HEAD_DIM)
    attn, new_k, new_v = attend(q, k, v, sink)
    u = c_gate * u_in
    up = jnp.concatenate([conv_past.astype(u.dtype), u], axis=1)
    conv = up[:, 0:t] * conv_w[0]
    for j in range(1, CONV_WIDTH):
        conv = conv + up[:, j:j + t] * conv_w[j]
    new_conv = up[:, -(CONV_WIDTH - 1):]
    y_a = (attn * jax.nn.silu(gate_a)) @ w_attn_out
    y_c = (b_gate * conv * jax.nn.silu(gate_c)) @ w_conv_out
    r = x + (jax.nn.sigmoid(merge_a) * y_a + jax.nn.sigmoid(merge_c) * y_c) @ w_o
    r = r + jax.nn.sigmoid(r @ w_ple_gate) * (p @ w_ple_proj)
    return r, new_k, new_v, new_conv


def setup_inputs(seed: int = 0) -> dict:
    key = jax.random.key(seed)
    ks = jax.random.split(key, 20)
    f32 = jnp.float32
    L = min(WINDOW, PAST_LEN)
    nrm = lambda k_, shape, s: jax.random.normal(k_, shape, f32) * s
    return {
        "x_prompt": nrm(ks[0], (BATCH, SEQ, D_MODEL), 1.0),
        "x_sample": nrm(ks[1], (DEC_BATCH, DEC_SEQ, D_MODEL), 1.0),
        "p_prompt": nrm(ks[2], (DEPTH, BATCH, SEQ, PLE_DIM), 1.0),
        "p_sample": nrm(ks[3], (DEPTH, DEC_BATCH, DEC_SEQ, PLE_DIM), 1.0),
        "cache_k": nrm(ks[4], (DEPTH, DEC_BATCH, L, N_KV_HEADS, HEAD_DIM), 1.0),
        "cache_v": nrm(ks[5], (DEPTH, DEC_BATCH, L, N_KV_HEADS, HEAD_DIM), 1.0),
        "state_conv": nrm(ks[6], (DEPTH, DEC_BATCH, CONV_WIDTH - 1, CONV_DIM), 1.0),
        "ln_g": 1.0 + nrm(ks[7], (DEPTH, D_MODEL), 0.05),
        "w_in": nrm(ks[8], (DEPTH, D_MODEL, IN_DIM), D_MODEL ** -0.5),
        "q_norm_g": 1.0 + nrm(ks[9], (DEPTH, HEAD_DIM), 0.05),
        "k_norm_g": 1.0 + nrm(ks[10], (DEPTH, HEAD_DIM), 0.05),
        "sink": nrm(ks[11], (DEPTH, N_HEADS), 0.5),
        "conv_w": nrm(ks[12], (DEPTH, CONV_WIDTH, CONV_DIM), CONV_WIDTH ** -0.5),
        "w_attn_out": nrm(ks[13], (DEPTH, ATTN_DIM, D_MODEL), ATTN_DIM ** -0.5),
        "w_conv_out": nrm(ks[14], (DEPTH, CONV_DIM, D_MODEL), CONV_DIM ** -0.5),
        "w_o": nrm(ks[15], (DEPTH, D_MODEL, D_MODEL), D_MODEL ** -0.5),
        "w_ple_gate": nrm(ks[16], (DEPTH, D_MODEL, D_MODEL), D_MODEL ** -0.5),
        "w_ple_proj": nrm(ks[17], (DEPTH, PLE_DIM, D_MODEL), PLE_DIM ** -0.5),
    }


def reference(x_prompt, x_sample, p_prompt, p_sample, cache_k, cache_v, state_conv,
              ln_g, w_in, q_norm_g, k_norm_g, sink, conv_w, w_attn_out, w_conv_out, w_o,
              w_ple_gate, w_ple_proj):
    t_p = x_prompt.shape[1]
    t_s = x_sample.shape[1]
    pos_p = jnp.arange(t_p, dtype=jnp.float32)
    pos_s = PAST_LEN + jnp.arange(t_s, dtype=jnp.float32)
    hp, hs = x_prompt, x_sample
    kp_l, vp_l, cp_l, ks_l, vs_l, cs_l = [], [], [], [], [], []
    for i in range(DEPTH):
        weights = (ln_g[i], w_in[i], q_norm_g[i], k_norm_g[i], sink[i], conv_w[i],
                   w_attn_out[i], w_conv_out[i], w_o[i], w_ple_gate[i], w_ple_proj[i])
        conv0 = jnp.zeros((hp.shape[0], CONV_WIDTH - 1, CONV_DIM), hp.dtype)
        hp, kp, vp, cp = hybrid_layer(hp, p_prompt[i], pos_p, conv0, attend_prompt, *weights)
        ck, cv = cache_k[i], cache_v[i]
        att_s = lambda q, k, v, s, ck=ck, cv=cv: attend_sample(q, k, v, s, ck, cv)
        hs, k_s, v_s, c_s = hybrid_layer(hs, p_sample[i], pos_s, state_conv[i], att_s, *weights)
        kp_l.append(kp); vp_l.append(vp); cp_l.append(cp)
        ks_l.append(k_s); vs_l.append(v_s); cs_l.append(c_s)
    return (hp, hs, jnp.stack(kp_l), jnp.stack(vp_l), jnp.stack(cp_l),
            jnp.stack(ks_l), jnp.stack(vs_l), jnp.stack(cs_l))
```

```cpp
#include <hip/hip_runtime.h>
#include <cstdio>
#include <cstdint>
constexpr int DM = 1024, TP = 16384, NSEQ = 32, TS = 32, MTOT = TP + NSEQ * TS  , PAST = 1024;
constexpr int NZ = 5376, PLE = 256;
constexpr size_t MiB = 1u << 20;
constexpr size_t WS_CTL = 0, CTL_ZERO_BYTES = 1 * MiB;
constexpr size_t WS_WIN = 1 * MiB;
constexpr size_t WS_WAB = 12 * MiB;
constexpr size_t WS_WO = 14 * MiB, WS_WPG = 16 * MiB;
constexpr size_t WS_WPP = 18 * MiB;
constexpr size_t WS_ROPE = 19 * MiB;
constexpr size_t WS_XN = 23 * MiB;
constexpr size_t WS_PB = 57 * MiB;
constexpr size_t WS_Q = 66 * MiB;
constexpr size_t WS_SGA = 83 * MiB;
constexpr size_t WS_KV = 100 * MiB;
constexpr size_t WS_U = 109 * MiB;
constexpr size_t WS_BG = 126 * MiB;
constexpr size_t WS_SMA = 143 * MiB;
constexpr size_t WS_SMB = 177 * MiB;
constexpr size_t WS_PP = 211 * MiB;
constexpr size_t WS_END = 245 * MiB;
static_assert((size_t)MTOT * 1024 * 2 <= 34 * MiB && (size_t)MTOT * 512 * 2 <= 17 * MiB && (size_t)MTOT * 256 * 2 <= 9 * MiB - MiB / 2 && (size_t)NZ * 1024 * 2 <= 11 * MiB, "d_ws map");
constexpr size_t WS_AB1 = WS_XN, WS_MM = WS_Q, WS_RB = WS_SMA;
namespace pg8 {
#define PG8_LAS __attribute__((address_space(3)))
typedef unsigned short bf16_t;
typedef short bf16x8 __attribute__((ext_vector_type(8)));
typedef float f32x4 __attribute__((ext_vector_type(4)));
typedef unsigned u32x4 __attribute__((ext_vector_type(4)));
constexpr int BM = 256, BK = 64, HALF = 128, HTB = HALF * BK * 2  , STAGE_BYTES = 8 * HTB, NXCD = 8, WGM = 8;

__host__ __device__ __forceinline__ int lds_byte(int r, int c) { const int st = (r >> 4) * 2 + (c >> 5), rr = r & 15, cc = c & 31, ob = rr * 64 + cc * 2; return st * 1024 + (ob ^ (((ob >> 9) & 1) << 5)); }
__host__ __device__ __forceinline__ void stage_rc(int b, int& R, int& C) { const int st = b / 1024, sb = b % 1024, swz = sb ^ (((sb >> 9) & 1) << 5); R = (st >> 1) * 16 + swz / 64; C = (st & 1) * 32 + (swz % 64) / 2; }
__host__ __device__ __forceinline__ int perm32(int rho) { const int n = rho >> 4, i = rho & 15; return 8 * (i >> 2) + 4 * n + (i & 3); }

struct Unit { int pm, pn; };
struct Gemm { const bf16_t* A; const bf16_t* Bt; int M, N, K; };

struct StaticOrder {
    int nM, nN, nwg, G, c;
    __host__ __device__ void init(int M, int N, int G_, int c_) { nM = M / BM; nN = N / BM; nwg = nM * nN; G = G_; c = c_; }
    __host__ __device__ bool next(int i, Unit& u) const {
        const long L = (long)i * G + c; if (L >= nwg) return false;
        int wgid = (int)L; { const int q = nwg / NXCD, r = nwg % NXCD, xcd = wgid % NXCD, off = wgid / NXCD; wgid = (xcd < r ? xcd * (q + 1) : r * (q + 1) + (xcd - r) * q) + off; }
        const int nig = WGM * nN, gid = wgid / nig, fm = gid * WGM, gsz = (nM - fm) < WGM ? (nM - fm) : WGM;
        u.pm = fm + ((wgid % nig) % gsz); u.pn = (wgid % nig) / gsz; return true;
    }
    __device__ __forceinline__ void a_ready(const Unit&) const {}
    __device__ __forceinline__ void done(const Unit&) const {}
};

constexpr size_t OFF_Y = 0, OFF_KP = 17825792, OFF_VP = 17842176, OFF_CP = 17858560, OFF_KS = 17859584, OFF_VS = 18383872, OFF_CS = 18908160, OUT_TOTAL = 18940928;
constexpr float QSCALE = 0.125f * 1.4426950408889634f;

typedef float f32x2 __attribute__((ext_vector_type(2)));
__device__ __forceinline__ unsigned cvt_pk_bf16(float lo, float hi) { unsigned r; asm volatile("v_cvt_pk_bf16_f32 %0, %1, %2" : "=v"(r) : "v"(lo), "v"(hi)); return r; }
__device__ __forceinline__ float bf_lo(unsigned w) { return __uint_as_float(w << 16); }
__device__ __forceinline__ float bf_hi(unsigned w) { return __uint_as_float(w & 0xffff0000u); }
__device__ __forceinline__ float sigm(float x) { return __builtin_amdgcn_rcpf(1.0f + __builtin_amdgcn_exp2f(-1.4426950408889634f * x)); }
__device__ __forceinline__ u32x4 pack8(const f32x4 a, const f32x4 b) { u32x4 w; w.x = cvt_pk_bf16(a[0], a[1]); w.y = cvt_pk_bf16(a[2], a[3]); w.z = cvt_pk_bf16(b[0], b[1]); w.w = cvt_pk_bf16(b[2], b[3]); return w; }
__device__ __forceinline__ void unpack8(const u32x4 w, f32x4& a, f32x4& b) { a = (f32x4){bf_lo(w.x), bf_hi(w.x), bf_lo(w.y), bf_hi(w.y)}; b = (f32x4){bf_lo(w.z), bf_hi(w.z), bf_lo(w.w), bf_hi(w.w)}; }
__device__ __forceinline__ f32x4 sigm4(const f32x4 v) { return (f32x4){sigm(v[0]), sigm(v[1]), sigm(v[2]), sigm(v[3])}; }

struct EpiZ {
    static constexpr bool PERM = true, AFTER_DRAIN = false, MID = false;
    unsigned char* ws; bf16_t *Q, *KV, *U, *BG; const float* rope; const float* qg; const float* kg; float* out;
    __device__ __forceinline__ void operator()(const f32x4 (&acc)[2][2][4][2], const Unit& u, int wr, int wc, int fr, int fq) const {
        const int pn = u.pn, rowb = u.pm * BM + wr * 64 + fr;
        if (pn < 3) {
            if (pn == 2 && wc >= 2) {
                const int vh = wc - 2;
#pragma unroll
                for (int ai = 0; ai < 2; ++ai)
#pragma unroll
                    for (int m = 0; m < 4; ++m) { const int row = rowb + ai * HALF + m * 16;
                        float* o32 = nullptr;
                        if (row >= TP) { const int b = (row - TP) >> 5, t = row & 31; o32 = out + OFF_VS + ((size_t)(b * 128 + 96 + t) * 128 + vh * 64 + 8 * fq); }
                        else if (row >= TP - 128) o32 = out + OFF_VP + ((size_t)(row - (TP - 128)) * 128 + vh * 64 + 8 * fq);
#pragma unroll
                        for (int bj = 0; bj < 2; ++bj) { const f32x4 v0 = acc[ai][bj][m][0], v1 = acc[ai][bj][m][1];
                            *(u32x4*)(KV + (size_t)row * 256 + 128 + vh * 64 + bj * 32 + 8 * fq) = pack8(v0, v1);
                            if (o32) { *(f32x4*)(o32 + bj * 32) = v0; *(f32x4*)(o32 + bj * 32 + 4) = v1; } } }
            } else {
                const bool isq = pn < 2; const float* g = isq ? qg : kg;
                const f32x4 g10 = *(const f32x4*)(g + 8 * fq), g11 = *(const f32x4*)(g + 8 * fq + 4), g20 = *(const f32x4*)(g + 32 + 8 * fq), g21 = *(const f32x4*)(g + 32 + 8 * fq + 4);
#pragma unroll
                for (int ai = 0; ai < 2; ++ai)
#pragma unroll
                    for (int m = 0; m < 4; ++m) { const int row = rowb + ai * HALF + m * 16; const int pos = row < TP ? row : PAST + (row & 31);
                        const f32x4 a0 = acc[ai][0][m][0], a1 = acc[ai][0][m][1], b0 = acc[ai][1][m][0], b1 = acc[ai][1][m][1];
                        float ss = (a0[0] * a0[0] + a0[1] * a0[1]) + (a0[2] * a0[2] + a0[3] * a0[3]) + (a1[0] * a1[0] + a1[1] * a1[1]) + (a1[2] * a1[2] + a1[3] * a1[3])
                                 + (b0[0] * b0[0] + b0[1] * b0[1]) + (b0[2] * b0[2] + b0[3] * b0[3]) + (b1[0] * b1[0] + b1[1] * b1[1]) + (b1[2] * b1[2] + b1[3] * b1[3]);
                        ss += __shfl_xor(ss, 16); ss += __shfl_xor(ss, 32);
                        const float rinv = __builtin_amdgcn_rsqf(ss * (1.0f / 64.0f) + 1e-6f);
                        const float* rp = rope + (size_t)pos * 64 + 16 * fq;
                        const f32x4 c0 = *(const f32x4*)(rp), c1 = *(const f32x4*)(rp + 4), c2 = *(const f32x4*)(rp + 8), c3 = *(const f32x4*)(rp + 12);
                        const f32x4 y10 = a0 * rinv * g10, y11 = a1 * rinv * g11, y20 = b0 * rinv * g20, y21 = b1 * rinv * g21;
                        const f32x4 cs0 = (f32x4){c0[0], c0[2], c1[0], c1[2]}, sn0 = (f32x4){c0[1], c0[3], c1[1], c1[3]}, cs1 = (f32x4){c2[0], c2[2], c3[0], c3[2]}, sn1 = (f32x4){c2[1], c2[3], c3[1], c3[3]};
                        f32x4 o10 = y10 * cs0 - y20 * sn0, o11 = y11 * cs1 - y21 * sn1, o20 = y20 * cs0 + y10 * sn0, o21 = y21 * cs1 + y11 * sn1;
                        if (isq) { const int head = 4 * pn + wc;
                            o10 = o10 * QSCALE; o11 = o11 * QSCALE; o20 = o20 * QSCALE; o21 = o21 * QSCALE;
                            bf16_t* qp = Q + (size_t)row * 512 + head * 64 + 8 * fq;
                            *(u32x4*)(qp) = pack8(o10, o11); *(u32x4*)(qp + 32) = pack8(o20, o21);
                        } else {
                            bf16_t* kp = KV + (size_t)row * 256 + wc * 64 + 8 * fq;
                            *(u32x4*)(kp) = pack8(o10, o11); *(u32x4*)(kp + 32) = pack8(o20, o21);
                            float* o32 = nullptr;
                            if (row >= TP) { const int b = (row - TP) >> 5, t = row & 31; o32 = out + OFF_KS + ((size_t)(b * 128 + 96 + t) * 128 + wc * 64 + 8 * fq); }
                            else if (row >= TP - 128) o32 = out + OFF_KP + ((size_t)(row - (TP - 128)) * 128 + wc * 64 + 8 * fq);
                            if (o32) { *(f32x4*)(o32) = o10; *(f32x4*)(o32 + 4) = o11; *(f32x4*)(o32 + 32) = o20; *(f32x4*)(o32 + 36) = o21; }
                        } }
            }
        } else if (pn < 5 || pn >= 13) {
            bf16_t* dst; int ld, colt; const bool gate = pn < 5;
            size_t wo; if (gate) { wo = WS_SGA; ld = 512; colt = 256 * (pn - 3); } else if (pn < 17) { wo = WS_SMA; ld = 1024; colt = 256 * (pn - 13); } else { wo = WS_SMB; ld = 1024; colt = 256 * (pn - 17); }
            dst = (bf16_t*)(ws + wo);
            const int col0 = colt + wc * 32 + 8 * fq;
#pragma unroll
            for (int ai = 0; ai < 2; ++ai)
#pragma unroll
                for (int m = 0; m < 4; ++m) { bf16_t* rowp = dst + (size_t)(rowb + ai * HALF + m * 16) * ld + col0;
#pragma unroll
                    for (int bj = 0; bj < 2; ++bj) { f32x4 v0 = acc[ai][bj][m][0], v1 = acc[ai][bj][m][1]; f32x4 s0 = sigm4(v0), s1 = sigm4(v1);
                        if (gate) { s0 = s0 * v0; s1 = s1 * v1; }
                        *(u32x4*)(rowp + bj * HALF) = pack8(s0, s1); } }
        } else if (pn < 9) {
            const int col0 = 128 * (pn - 5) + wc * 32 + 8 * fq;
#pragma unroll
            for (int ai = 0; ai < 2; ++ai)
#pragma unroll
                for (int m = 0; m < 4; ++m) { const f32x4 b0 = acc[ai][0][m][0], b1 = acc[ai][0][m][1], g0 = acc[ai][1][m][0], g1 = acc[ai][1][m][1];
                    *(u32x4*)(BG + (size_t)(rowb + ai * HALF + m * 16) * 512 + col0) = pack8(b0 * g0 * sigm4(g0), b1 * g1 * sigm4(g1)); }
        } else {
            const int col0 = 128 * (pn - 9) + wc * 32 + 8 * fq;
#pragma unroll
            for (int ai = 0; ai < 2; ++ai)
#pragma unroll
                for (int m = 0; m < 4; ++m) { const int row = rowb + ai * HALF + m * 16;
                    const f32x4 u0 = acc[ai][0][m][0] * acc[ai][1][m][0], u1 = acc[ai][0][m][1] * acc[ai][1][m][1];
                    *(u32x4*)(U + (size_t)row * 512 + col0) = pack8(u0, u1);
                    float* o32 = nullptr;
                    if (row >= TP) { if ((row & 31) >= 30) o32 = out + OFF_CS + (size_t)(((row - TP) >> 5) * 2 + ((row & 31) - 30)) * 512 + col0; }
                    else if (row >= TP - 2) o32 = out + OFF_CP + (size_t)(row - (TP - 2)) * 512 + col0;
                    if (o32) { *(f32x4*)(o32) = u0; *(f32x4*)(o32 + 4) = u1; } }
        }
    }
};
struct EpiStore {
    static constexpr bool PERM = true, AFTER_DRAIN = false, MID = false;
    bf16_t* O; int ldc;
    __device__ __forceinline__ void operator()(const f32x4 (&acc)[2][2][4][2], const Unit& u, int wr, int wc, int fr, int fq) const {
        const int rowb = u.pm * BM + wr * 64 + fr, col0 = u.pn * BM + wc * 32 + 8 * fq;
#pragma unroll
        for (int ai = 0; ai < 2; ++ai)
#pragma unroll
            for (int m = 0; m < 4; ++m) { bf16_t* rowp = O + (size_t)(rowb + ai * HALF + m * 16) * ldc + col0;
#pragma unroll
                for (int bj = 0; bj < 2; ++bj) *(u32x4*)(rowp + bj * HALF) = pack8(acc[ai][bj][m][0], acc[ai][bj][m][1]); }
    }
};
struct EpiMerge {
    static constexpr bool PERM = true, AFTER_DRAIN = false, MID = true;
    const bf16_t *SMA, *SMB; bf16_t* MM;
    __device__ __forceinline__ void mid(f32x4 (&acc)[2][2][4][2], const Unit& u, int wr, int wc, int fr, int fq) const {
        int rowb = u.pm * BM + wr * 64 + fr, col0 = u.pn * BM + wc * 32 + 8 * fq;
        asm volatile("" : "+v"(rowb), "+v"(col0));
#pragma unroll
        for (int ai = 0; ai < 2; ++ai)
#pragma unroll
            for (int m = 0; m < 4; ++m) { const size_t off = (size_t)(rowb + ai * HALF + m * 16) * DM + col0;
#pragma unroll
                for (int bj = 0; bj < 2; ++bj) { const u32x4 wa = *(const u32x4*)(SMA + off + bj * HALF), wb = *(const u32x4*)(SMB + off + bj * HALF);
                    f32x4 a0, a1, b0, b1; unpack8(wa, a0, a1); unpack8(wb, b0, b1);
#pragma unroll
                    for (int e = 0; e < 4; ++e) { acc[ai][bj][m][0][e] *= a0[e] * __builtin_amdgcn_rcpf(fmaxf(b0[e], 1e-18f)); acc[ai][bj][m][1][e] *= a1[e] * __builtin_amdgcn_rcpf(fmaxf(b1[e], 1e-18f)); } }
                asm volatile("" ::: "memory"); }
    }
    __device__ __forceinline__ void operator()(const f32x4 (&acc)[2][2][4][2], const Unit& u, int wr, int wc, int fr, int fq) const {
        const int rowb = u.pm * BM + wr * 64 + fr, col0 = u.pn * BM + wc * 32 + 8 * fq;
#pragma unroll
        for (int ai = 0; ai < 2; ++ai)
#pragma unroll
            for (int m = 0; m < 4; ++m) { const size_t off = (size_t)(rowb + ai * HALF + m * 16) * DM + col0;
#pragma unroll
                for (int bj = 0; bj < 2; ++bj) { const u32x4 wb = *(const u32x4*)(SMB + off + bj * HALF); f32x4 b0, b1; unpack8(wb, b0, b1);
#pragma unroll
                    for (int e = 0; e < 4; ++e) { b0[e] = fmaxf(b0[e], 1e-18f); b1[e] = fmaxf(b1[e], 1e-18f); }
                    *(u32x4*)(MM + off + bj * HALF) = pack8(acc[ai][bj][m][0] * b0, acc[ai][bj][m][1] * b1); } }
    }
};
struct EpiResid {
    static constexpr bool PERM = true, AFTER_DRAIN = false, MID = false;
    const float *xp, *xs; float* out; bf16_t* RB;
    __device__ __forceinline__ void operator()(const f32x4 (&acc)[2][2][4][2], const Unit& u, int wr, int wc, int fr, int fq) const {
        const int rowb = u.pm * BM + wr * 64 + fr, col0 = u.pn * BM + wc * 32 + 8 * fq;
        const float* xb = (u.pm * BM < TP) ? xp : xs - (size_t)TP * DM;
#pragma unroll
        for (int ai = 0; ai < 2; ++ai)
#pragma unroll
            for (int m = 0; m < 4; ++m) { const size_t off = (size_t)(rowb + ai * HALF + m * 16) * DM + col0;
#pragma unroll
                for (int bj = 0; bj < 2; ++bj) { const f32x4 r0 = acc[ai][bj][m][0] + *(const f32x4*)(xb + off + bj * HALF), r1 = acc[ai][bj][m][1] + *(const f32x4*)(xb + off + bj * HALF + 4);
                    *(f32x4*)(out + off + bj * HALF) = r0; *(f32x4*)(out + off + bj * HALF + 4) = r1; *(u32x4*)(RB + off + bj * HALF) = pack8(r0, r1); } }
    }
};
struct EpiOut {
    static constexpr bool PERM = true, AFTER_DRAIN = false, MID = false;
    float* out; const bf16_t* PP;
    __device__ __forceinline__ void operator()(const f32x4 (&acc)[2][2][4][2], const Unit& u, int wr, int wc, int fr, int fq) const {
        const int rowb = u.pm * BM + wr * 64 + fr, col0 = u.pn * BM + wc * 32 + 8 * fq;
#pragma unroll
        for (int ai = 0; ai < 2; ++ai)
#pragma unroll
            for (int m = 0; m < 4; ++m) { const size_t off = (size_t)(rowb + ai * HALF + m * 16) * DM + col0;
#pragma unroll
                for (int bj = 0; bj < 2; ++bj) { const u32x4 wp = *(const u32x4*)(PP + off + bj * HALF); f32x4 p0, p1; unpack8(wp, p0, p1);
                    const f32x4 r0 = *(const f32x4*)(out + off + bj * HALF), r1 = *(const f32x4*)(out + off + bj * HALF + 4);
                    *(f32x4*)(out + off + bj * HALF) = r0 + sigm4(acc[ai][bj][m][0]) * p0; *(f32x4*)(out + off + bj * HALF + 4) = r1 + sigm4(acc[ai][bj][m][1]) * p1; } }
    }
};

template <class Epi, class Sched, bool ALIGN_EPI = false, bool SP2 = false>
__device__ __forceinline__ void gemm_phase(PG8_LAS unsigned char* lds, const Gemm g, const Sched& S, const Epi& E) {
    const int tid = threadIdx.x, wid = __builtin_amdgcn_readfirstlane(tid >> 6), lane = tid & 63, wr = wid >> 2, wc = wid & 3, fr = lane & 15, fq = lane >> 4;
    const int K = g.K, nt = K / BK;
    unsigned voffA[2], voffB[2];
#pragma unroll
    for (int i = 0; i < 2; ++i) { int R, C; stage_rc(tid * 16 + i * 8192, R, C); const int Rb = Epi::PERM ? ((R & ~31) + perm32(R & 31)) : R;
        voffA[i] = (unsigned)(R * K + C) * 2u; voffB[i] = (unsigned)(Rb * K + C) * 2u; }
    const size_t kstep = (size_t)(BK * 2);
    const size_t hstep = (size_t)HALF * K * 2;
    const size_t tstep = 2 * hstep;
    const unsigned ldsw = (unsigned)wid * 1024u;
    const int aoff = lds_byte(wr * 64 + fr, fq * 8), boff = lds_byte(wc * 32 + fr, fq * 8);
#define PG8_SA(b, h) (((b) * 2 + (h)) * HTB)
#define PG8_SB(b, h) ((4 + (b) * 2 + (h)) * HTB)
#define PG8_STAGE(bufoff, gbase, voff) do { _Pragma("unroll") for (int _i = 0; _i < 2; ++_i) \
        __builtin_amdgcn_global_load_lds((const unsigned*)((const char*)(gbase) + (voff)[_i]), (PG8_LAS unsigned*)(lds + (bufoff) + ldsw + _i * 8192), 16, 0, 0); } while (0)
#define PG8_LDA(dst, b, h) do { _Pragma("unroll") for (int m = 0; m < 4; ++m) _Pragma("unroll") for (int k = 0; k < 2; ++k) dst[m][k] = *(const PG8_LAS bf16x8*)(lds + PG8_SA(b, h) + aoff + m * 2048 + k * 1024); } while (0)
#define PG8_LDB(dst, b, h) do { _Pragma("unroll") for (int n = 0; n < 2; ++n) _Pragma("unroll") for (int k = 0; k < 2; ++k) dst[n][k] = *(const PG8_LAS bf16x8*)(lds + PG8_SB(b, h) + boff + n * 2048 + k * 1024); } while (0)
#define PG8_MMA(ai, bj, At, Bt) do { __builtin_amdgcn_s_setprio(1); _Pragma("unroll") for (int m = 0; m < 4; ++m) _Pragma("unroll") for (int n = 0; n < 2; ++n) _Pragma("unroll") for (int k = 0; k < 2; ++k) \
        acc[ai][bj][m][n] = __builtin_amdgcn_mfma_f32_16x16x32_bf16(Bt[n][k], At[m][k], acc[ai][bj][m][n], 0, 0, 0); __builtin_amdgcn_s_setprio(0); } while (0)
#define PG8_WAIT_V(n) asm volatile("s_waitcnt vmcnt(" #n ")" ::: "memory")
#define PG8_WAIT_L(n) asm volatile("s_waitcnt lgkmcnt(" #n ")" ::: "memory")
#define PG8_BAR __builtin_amdgcn_s_barrier()
#define PG8_SCHED __builtin_amdgcn_sched_barrier(0)
    Unit cur, nxt; int ui = 0;
    if (!S.next(0, cur)) return;
    f32x4 acc[2][2][4][2];
#pragma unroll
    for (int a = 0; a < 2; ++a)
#pragma unroll
        for (int b = 0; b < 2; ++b)
#pragma unroll
            for (int m = 0; m < 4; ++m)
#pragma unroll
                for (int n = 0; n < 2; ++n) acc[a][b][m][n] = (f32x4){0.f, 0.f, 0.f, 0.f};
    bf16x8 At[4][2], B0[2][2], B1[2][2];
    const char* cA = (const char*)g.A + (size_t)cur.pm * tstep; const char* cB = (const char*)g.Bt + (size_t)cur.pn * tstep;
    S.a_ready(cur);
    if constexpr (SP2) {
        PG8_STAGE(PG8_SB(0, 0), cB, voffB); PG8_STAGE(PG8_SB(0, 1), cB + hstep, voffB); PG8_STAGE(PG8_SA(0, 0), cA, voffA); PG8_STAGE(PG8_SA(0, 1), cA + hstep, voffA);
        if (wr == 1) PG8_BAR;
        PG8_WAIT_V(2); PG8_BAR;
        PG8_STAGE(PG8_SB(1, 0), cB + kstep, voffB); PG8_STAGE(PG8_SA(1, 0), cA + kstep, voffA); PG8_STAGE(PG8_SB(1, 1), cB + hstep + kstep, voffB);
        PG8_WAIT_V(6); PG8_BAR;
    } else {
        PG8_STAGE(PG8_SB(0, 0), cB, voffB); PG8_STAGE(PG8_SA(0, 0), cA, voffA); PG8_STAGE(PG8_SB(0, 1), cB + hstep, voffB); PG8_STAGE(PG8_SA(0, 1), cA + hstep, voffA);
        if (wr == 1) PG8_BAR;
        PG8_WAIT_V(4); PG8_BAR;
        PG8_STAGE(PG8_SB(1, 0), cB + kstep, voffB); PG8_STAGE(PG8_SA(1, 0), cA + kstep, voffA); PG8_STAGE(PG8_SB(1, 1), cB + hstep + kstep, voffB);
        PG8_WAIT_V(6); PG8_BAR;
    }
    for (;;) {
        const bool has_next = S.next(ui + 1, nxt);
        const char* nA = has_next ? (const char*)g.A + (size_t)nxt.pm * tstep : cA; const char* nB = has_next ? (const char*)g.Bt + (size_t)nxt.pn * tstep : cB;
        for (int t = 0; t < nt; t += 2) {
            if constexpr (Epi::MID) { if (t == (nt >> 1)) E.mid(acc, cur, wr, wc, fr, fq); }
            const bool last = (t == nt - 2);
            const char* a1 = cA + (size_t)(t + 1) * kstep;
            const char* a2 = last ? nA : cA + (size_t)(t + 2) * kstep; const char* b2 = last ? nB : cB + (size_t)(t + 2) * kstep;
            const char* a3 = a2 + kstep; const char* b3 = b2 + kstep;
            if (last && has_next) S.a_ready(nxt);
            if constexpr (SP2) {
            PG8_LDB(B0, 0, 0); PG8_LDB(B1, 0, 1); PG8_SCHED; PG8_LDA(At, 0, 0); PG8_STAGE(PG8_SA(1, 1), a1 + hstep, voffA);
            PG8_WAIT_V(8); PG8_WAIT_L(0); PG8_BAR; PG8_MMA(0, 0, At, B0); PG8_MMA(0, 1, At, B1); PG8_BAR; PG8_SCHED;
            PG8_LDA(At, 0, 1); PG8_STAGE(PG8_SB(0, 0), b2, voffB); PG8_STAGE(PG8_SB(0, 1), b2 + hstep, voffB); PG8_STAGE(PG8_SA(0, 0), a2, voffA);
            PG8_WAIT_V(8); PG8_WAIT_L(0); PG8_BAR; PG8_MMA(1, 0, At, B0); PG8_MMA(1, 1, At, B1); PG8_BAR; PG8_SCHED;
            PG8_LDB(B0, 1, 0); PG8_LDB(B1, 1, 1); PG8_SCHED; PG8_LDA(At, 1, 0); PG8_STAGE(PG8_SA(0, 1), a2 + hstep, voffA);
            PG8_WAIT_V(8); PG8_WAIT_L(0); PG8_BAR; PG8_MMA(0, 0, At, B0); PG8_MMA(0, 1, At, B1); PG8_BAR; PG8_SCHED;
            PG8_LDA(At, 1, 1); PG8_STAGE(PG8_SB(1, 0), b3, voffB); PG8_STAGE(PG8_SB(1, 1), b3 + hstep, voffB); PG8_STAGE(PG8_SA(1, 0), a3, voffA);
            PG8_WAIT_V(8); PG8_WAIT_L(0); PG8_BAR; PG8_MMA(1, 0, At, B0); PG8_MMA(1, 1, At, B1); PG8_BAR; PG8_SCHED;
            } else {
            PG8_LDB(B0, 0, 0); PG8_SCHED; PG8_LDA(At, 0, 0); PG8_STAGE(PG8_SA(1, 1), a1 + hstep, voffA);
            PG8_WAIT_L(8); PG8_BAR; PG8_WAIT_L(0); PG8_MMA(0, 0, At, B0); PG8_BAR; PG8_SCHED;
            PG8_LDB(B1, 0, 1); PG8_STAGE(PG8_SB(0, 0), b2, voffB);
            PG8_BAR; PG8_WAIT_L(0); PG8_MMA(0, 1, At, B1); PG8_BAR;
            PG8_LDA(At, 0, 1); PG8_STAGE(PG8_SA(0, 0), a2, voffA);
            PG8_BAR; PG8_WAIT_L(0); PG8_MMA(1, 0, At, B0); PG8_BAR; PG8_SCHED;
            PG8_STAGE(PG8_SB(0, 1), b2 + hstep, voffB);
            PG8_WAIT_V(6); PG8_BAR; PG8_MMA(1, 1, At, B1); PG8_BAR;
            PG8_LDB(B0, 1, 0); PG8_SCHED; PG8_LDA(At, 1, 0); PG8_STAGE(PG8_SA(0, 1), a2 + hstep, voffA);
            PG8_WAIT_L(8); PG8_BAR; PG8_WAIT_L(0); PG8_MMA(0, 0, At, B0); PG8_BAR; PG8_SCHED;
            PG8_LDB(B1, 1, 1); PG8_STAGE(PG8_SB(1, 0), b3, voffB);
            PG8_BAR; PG8_WAIT_L(0); PG8_MMA(0, 1, At, B1); PG8_BAR;
            PG8_LDA(At, 1, 1); PG8_STAGE(PG8_SA(1, 0), a3, voffA);
            PG8_BAR; PG8_WAIT_L(0); PG8_MMA(1, 0, At, B0); PG8_BAR; PG8_SCHED;
            PG8_STAGE(PG8_SB(1, 1), b3 + hstep, voffB);
            PG8_WAIT_V(6); PG8_BAR; PG8_MMA(1, 1, At, B1); PG8_BAR;
            }
        }
        if constexpr (ALIGN_EPI) { if (wr == 0) PG8_BAR; }
        if constexpr (!Epi::AFTER_DRAIN) { E(acc, cur, wr, wc, fr, fq); S.done(cur); }
        if (!has_next) break;
#pragma unroll
        for (int a = 0; a < 2; ++a)
#pragma unroll
            for (int b = 0; b < 2; ++b)
#pragma unroll
                for (int m = 0; m < 4; ++m)
#pragma unroll
                    for (int n = 0; n < 2; ++n) acc[a][b][m][n] = (f32x4){0.f, 0.f, 0.f, 0.f};
        cur = nxt; cA = nA; cB = nB; ++ui;
        if constexpr (ALIGN_EPI) { if (wr == 1) PG8_BAR; }
    }
    PG8_WAIT_V(0);
    if constexpr (!ALIGN_EPI) { if (wr == 0) PG8_BAR; }
    PG8_BAR;
    if constexpr (Epi::AFTER_DRAIN) { E.fused(acc, cur, wr, wc, fr, fq, lds, wid, lane); S.done(cur); }
#undef PG8_SA
#undef PG8_SB
#undef PG8_STAGE
#undef PG8_LDA
#undef PG8_LDB
#undef PG8_MMA
#undef PG8_WAIT_V
#undef PG8_WAIT_L
#undef PG8_BAR
#undef PG8_SCHED
}
}

#ifndef PG8_SP2
#define PG8_SP2 true
#endif
#ifndef PG8_ALIGN
#define PG8_ALIGN true
#endif
constexpr int NWAVES = 8;
#ifndef MK_N_LAUNCHES
#define MK_N_LAUNCHES 6
#endif
constexpr int N_LAUNCHES = MK_N_LAUNCHES;
constexpr int PER_PHASE = 6;

constexpr int CW_BAR = 4096;

constexpr int RING_OFF = 0, RING_BYTES = 131072;
constexpr int LDSCTL_OFF = RING_BYTES, MISC_OFF = LDSCTL_OFF + 320;
constexpr int LDS_BYTES = 147456;
static_assert(MISC_OFF + 128 <= LDS_BYTES, "LDS map");

#define GAS __attribute__((address_space(1)))
#define LAS __attribute__((address_space(3)))
typedef unsigned short bf16;
typedef unsigned v4u __attribute__((ext_vector_type(4)));
typedef unsigned v2u __attribute__((ext_vector_type(2)));
typedef float f32x4 __attribute__((ext_vector_type(4)));
typedef float f32x16 __attribute__((ext_vector_type(16)));
typedef short bf16x8 __attribute__((ext_vector_type(8)));
typedef short s16x4 __attribute__((ext_vector_type(4)));
typedef GAS unsigned gu32;
typedef GAS unsigned long long gu64;
#define RLX_AGENT __ATOMIC_RELAXED, __HIP_MEMORY_SCOPE_AGENT
#define LDS_WAIT() asm volatile("s_waitcnt lgkmcnt(0)" ::: "memory")
#define VM_WAIT() asm volatile("s_waitcnt vmcnt(0)" ::: "memory")
__device__ __forceinline__ unsigned f2bf(float f) { unsigned u = __builtin_bit_cast(unsigned, f); return (u + 0x7fffu + ((u >> 16) & 1u)) >> 16; }
__device__ __forceinline__ unsigned pk2(float lo, float hi) { return f2bf(lo) | (f2bf(hi) << 16); }
__device__ __forceinline__ float bflo(unsigned w) { return __uint_as_float(w << 16); }
__device__ __forceinline__ float bfhi(unsigned w) { return __uint_as_float(w & 0xffff0000u); }

#define XB_TMO      128
#define XB_XCNT(j)  (256  + 64 * (j))
#define XB_XSUB(j)  (1280 + 64 * (j))
#define XB_XGEN(j)  (2304 + 64 * (j))
#define XB_TOP      3328
#define XB_TOPGEN   3392
#define XCD_BAR_WORDS 3456
#define XB_SPIN_CAP (1u << 18)

__device__ __forceinline__ unsigned xb_ld(unsigned* p)              { return __hip_atomic_load(p, __ATOMIC_RELAXED, __HIP_MEMORY_SCOPE_AGENT); }
__device__ __forceinline__ unsigned xb_add(unsigned* p, unsigned v) { return __hip_atomic_fetch_add(p, v, __ATOMIC_RELAXED, __HIP_MEMORY_SCOPE_AGENT); }
__device__ __forceinline__ unsigned xb_xcc_id() { return (unsigned)__builtin_amdgcn_s_getreg((3 << 11) | 20) & 0xFu; }
#define XB_SPIN(cond, bar) do { unsigned _sp = 0; while (cond) { __builtin_amdgcn_s_sleep(1); \
    if ((++_sp & 255u) == 0u) { if (xb_ld(&(bar)[XB_TMO])) break; if (_sp > XB_SPIN_CAP) { atomicAdd(&(bar)[XB_TMO], 1u); break; } } } } while (0)

struct XcdBarrier {
    unsigned* bar; unsigned x;
    volatile LAS unsigned* st;
};

__device__ __forceinline__ XcdBarrier xcd_barrier_post(unsigned* bar, volatile LAS unsigned* st) {
    XcdBarrier b; b.bar = bar; b.x = xb_xcc_id(); b.st = st;
    if (threadIdx.x == 0) (void)xb_add(&bar[XB_XCNT(b.x)], 1u);
    return b;
}
__device__ __forceinline__ void xcd_barrier_complete(unsigned* bar, unsigned x, unsigned& nloc, unsigned& nx) {
    const unsigned G = gridDim.x * gridDim.y * gridDim.z;
    unsigned sum, cnt, mine, sp = 0u;
    for (;;) {
        sum = 0u; cnt = 0u; mine = 0u;
#pragma unroll
        for (unsigned j = 0; j < 16; ++j) { const unsigned c = xb_ld(&bar[XB_XCNT(j)]); sum += c; cnt += (c > 0u) ? 1u : 0u; mine = (j == x) ? c : mine; }
        if (sum == G) break;
        __builtin_amdgcn_s_sleep(1);
        if ((++sp & 255u) == 0u) { if (xb_ld(&bar[XB_TMO])) break; if (sp > XB_SPIN_CAP) { atomicAdd(&bar[XB_TMO], 1u); break; } }
    }
    nloc = mine > 0u ? mine : 1u; nx = cnt > 0u ? cnt : 1u;
}

__device__ __forceinline__ void xcd_barrier(const XcdBarrier& b) {
    asm volatile("s_waitcnt vmcnt(0)" ::: "memory");
    __syncthreads();
    if (threadIdx.x == 0) {
        unsigned* bar = b.bar;
        __builtin_amdgcn_s_waitcnt(0);
        unsigned nloc = b.st[0], nx = b.st[1];
        if (nloc == 0u) { xcd_barrier_complete(bar, b.x, nloc, nx); b.st[0] = nloc; b.st[1] = nx; }
        const unsigned old = xb_add(&bar[XB_XSUB(b.x)], 1u);
        const unsigned gen = old / nloc;
        if (old + 1u == (gen + 1u) * nloc) {
            __builtin_amdgcn_fence(__ATOMIC_RELEASE, "agent");
            asm volatile("s_waitcnt vmcnt(0)" ::: "memory");
            const unsigned og = xb_add(&bar[XB_TOP], 1u);
            const unsigned tg = og / nx;
            if (og + 1u == (tg + 1u) * nx) xb_add(&bar[XB_TOPGEN], 1u);
            else XB_SPIN(xb_ld(&bar[XB_TOPGEN]) == tg, bar);
            __builtin_amdgcn_fence(__ATOMIC_ACQUIRE, "agent");
            xb_add(&bar[XB_XGEN(b.x)], 1u);
            asm volatile("s_waitcnt vmcnt(0)" ::: "memory");
        } else {
            XB_SPIN(xb_ld(&bar[XB_XGEN(b.x)]) == gen, bar);
            __builtin_amdgcn_fence(__ATOMIC_ACQUIRE, "agent");
            asm volatile("s_waitcnt vmcnt(0)" ::: "memory");
        }
    }
    __syncthreads();
}

static __device__ const float INVF[32] = {1.000000000e+00f, 7.498942018e-01f, 5.623413324e-01f, 4.216965139e-01f, 3.162277639e-01f, 2.371373773e-01f, 1.778279394e-01f, 1.333521456e-01f,
    1.000000015e-01f, 7.498942316e-02f, 5.623413250e-02f, 4.216964915e-02f, 3.162277490e-02f, 2.371373773e-02f, 1.778279431e-02f, 1.333521400e-02f,
    9.999999776e-03f, 7.498942316e-03f, 5.623413250e-03f, 4.216964822e-03f, 3.162277630e-03f, 2.371373819e-03f, 1.778279431e-03f, 1.333521446e-03f,
    1.000000047e-03f, 7.498941850e-04f, 5.623413017e-04f, 4.216965172e-04f, 3.162277571e-04f, 2.371373703e-04f, 1.778279402e-04f, 1.333521504e-04f};
__device__ __forceinline__ float wave_sum(float v) {
#pragma unroll
    for (int o = 1; o < 64; o <<= 1) v += __shfl_xor(v, o);
    return v;
}
__device__ __forceinline__ int zmap(int n0) {
    if (n0 < 512) { const int head = n0 >> 6, bj = (n0 >> 5) & 1; return 256 * (head >> 2) + 128 * bj + 32 * (head & 3); }
    if (n0 < 768) { const int r = n0 - 512; return 512 + 128 * ((r >> 5) & 1) + 32 * (r >> 6); }
    if (n0 < 1280) return n0;
    if (n0 < 1792) { const int r = n0 - 1280; return 256 * (5 + (r >> 7)) + (r & 127); }
    if (n0 < 2304) { const int r = n0 - 1792; return 256 * (9 + (r >> 7)) + (r & 127); }
    if (n0 < 2816) { const int r = n0 - 2304; return 256 * (9 + (r >> 7)) + 128 + (r & 127); }
    if (n0 < 3328) { const int r = n0 - 2816; return 256 * (5 + (r >> 7)) + 128 + (r & 127); }
    return n0;
}
__device__ __forceinline__ void p0_transpose_item(const float* W, int N, int k0, int n0, bf16* WT, int Kd, int drow0, int dcol0, LAS float* scr, int lane) {
#pragma unroll 8
    for (int i = 0; i < 32; ++i) { const int kk = 2 * i + (lane >> 5); scr[kk * 33 + (lane & 31)] = W[(size_t)(k0 + kk) * N + n0 + (lane & 31)]; }
    LDS_WAIT(); asm volatile("" ::: "memory");
    const int c = lane & 7;
#pragma unroll
    for (int j = 0; j < 4; ++j) { const int n = (lane >> 3) + 8 * j; const LAS float* s = scr + (8 * c) * 33 + n;
        v4u o; o.x = pk2(s[0 * 33], s[1 * 33]); o.y = pk2(s[2 * 33], s[3 * 33]); o.z = pk2(s[4 * 33], s[5 * 33]); o.w = pk2(s[6 * 33], s[7 * 33]);
        *(GAS v4u*)(WT + (size_t)(drow0 + n) * Kd + dcol0 + 8 * c) = o; }
    LDS_WAIT(); asm volatile("" ::: "memory");
}
struct Args { const float* in[18]; float* out; unsigned char* ws; int ph_lo, ph_hi, li, pad; };
enum { I_XP = 0, I_XS, I_PP, I_PS, I_CK, I_CV, I_SC, I_LNG, I_WIN, I_QG, I_KG, I_SINK, I_CW, I_WA, I_WB, I_WO, I_WPG, I_WPP };

__device__ __forceinline__ void p0_prologue(const Args& A, LAS unsigned char* lds, int gw, int NGW, int wave, int lane) {
    unsigned char* ws = A.ws;
    LAS float* scr = (LAS float*)(lds + RING_OFF + wave * 16384);
    constexpr int I_IN = 16 * 168, I_A = 8 * 32, I_O = 16 * 32, I_P = 4 * 32, NITEMS = I_IN + 2 * I_A + 2 * I_O + I_P;
    for (int it = gw; it < NITEMS; it += NGW) {
        int r = it;
        if (r < I_IN) { const int kb = r / 168, nb = r % 168; p0_transpose_item(A.in[I_WIN], NZ, 64 * kb, 32 * nb, (bf16*)(ws + WS_WIN), 1024, zmap(32 * nb), 64 * kb, scr, lane); continue; } r -= I_IN;
        if (r < I_A) { const int kb = r >> 5, nb = r & 31; p0_transpose_item(A.in[I_WA], DM, 64 * kb, 32 * nb, (bf16*)(ws + WS_WAB), 1024, 32 * nb, 64 * kb, scr, lane); continue; } r -= I_A;
        if (r < I_A) { const int kb = r >> 5, nb = r & 31; p0_transpose_item(A.in[I_WB], DM, 64 * kb, 32 * nb, (bf16*)(ws + WS_WAB), 1024, 32 * nb, 512 + 64 * kb, scr, lane); continue; } r -= I_A;
        if (r < I_O) { const int kb = r >> 5, nb = r & 31; p0_transpose_item(A.in[I_WO], DM, 64 * kb, 32 * nb, (bf16*)(ws + WS_WO), 1024, 32 * nb, 64 * kb, scr, lane); continue; } r -= I_O;
        if (r < I_O) { const int kb = r >> 5, nb = r & 31; p0_transpose_item(A.in[I_WPG], DM, 64 * kb, 32 * nb, (bf16*)(ws + WS_WPG), 1024, 32 * nb, 64 * kb, scr, lane); continue; } r -= I_O;
        { const int kb = r >> 5, nb = r & 31; p0_transpose_item(A.in[I_WPP], DM, 64 * kb, 32 * nb, (bf16*)(ws + WS_WPP), 256, 32 * nb, 64 * kb, scr, lane); }
    }
    for (int m = gw; m < MTOT; m += NGW) {
        const float* xrow = m < TP ? A.in[I_XP] + (size_t)m * DM : A.in[I_XS] + (size_t)(m - TP) * DM;
        const GAS f32x4* xr = (const GAS f32x4*)xrow + lane; const GAS f32x4* gr = (const GAS f32x4*)A.in[I_LNG] + lane;
        f32x4 v[4]; float s = 0.f;
#pragma unroll
        for (int j = 0; j < 4; ++j) { v[j] = xr[64 * j]; s += (v[j].x * v[j].x + v[j].y * v[j].y) + (v[j].z * v[j].z + v[j].w * v[j].w); }
        const float rinv = __builtin_amdgcn_rsqf(wave_sum(s) * (1.f / DM) + 1e-6f);
        GAS unsigned long long* o8 = (GAS unsigned long long*)((bf16*)(ws + WS_XN) + (size_t)m * DM) + lane;
#pragma unroll
        for (int j = 0; j < 4; ++j) { const f32x4 g = gr[64 * j]; o8[64 * j] = (unsigned long long)pk2(v[j].x * rinv * g.x, v[j].y * rinv * g.y) | ((unsigned long long)pk2(v[j].z * rinv * g.z, v[j].w * rinv * g.w) << 32); }
        const float* prow = m < TP ? A.in[I_PP] + (size_t)m * PLE : A.in[I_PS] + (size_t)(m - TP) * PLE;
        const f32x4 pv = ((const GAS f32x4*)prow)[lane];
        ((GAS unsigned long long*)((bf16*)(ws + WS_PB) + (size_t)m * PLE))[lane] = (unsigned long long)pk2(pv.x, pv.y) | ((unsigned long long)pk2(pv.z, pv.w) << 32);
    }
    for (int idx = gw * 64 + lane; idx < TP * 32; idx += NGW * 64) {
        const int pos = idx >> 5, i = idx & 31;
        const float angf = (float)pos * INVF[i];
        const double a = (double)angf, k = __builtin_rint(a * 0.15915494309189535);
        double r = __builtin_fma(-k, 6.283185307179586, a); r = __builtin_fma(-k, 2.4492935982947064e-16, r);
        const float rf = (float)r;
        pg8::f32x2 cs; cs.x = cosf(rf); cs.y = sinf(rf);
        ((GAS pg8::f32x2*)(ws + WS_ROPE))[idx] = cs;
    }
    for (int idx = gw * 64 + lane; idx < 2 * NSEQ * 3072; idx += NGW * 64) {
        const int which = idx >= NSEQ * 3072, r0 = idx - which * NSEQ * 3072, b = r0 / 3072, r = r0 % 3072;
        const f32x4 v = *(const GAS f32x4*)(A.in[which ? I_CV : I_CK] + (size_t)b * 16384 + 4096 + 4 * r);
        *(GAS f32x4*)(A.out + (which ? pg8::OFF_VS : pg8::OFF_KS) + (size_t)b * 16384 + 4 * r) = v;
    }
}

constexpr int ATT_K_OFF = 0, ATT_VT_OFF = 40960, VT_PITCH = 392;
static_assert(ATT_VT_OFF + 128 * VT_PITCH <= RING_BYTES, "attention LDS");
__device__ __forceinline__ unsigned cvtpk(float lo, float hi) { unsigned r; asm volatile("v_cvt_pk_bf16_f32 %0, %1, %2" : "=v"(r) : "v"(lo), "v"(hi)); return r; }
__device__ __forceinline__ void attn_wave(const LAS unsigned char* kimg, const LAS unsigned char* vtimg, int nkt, const bf16* qrow, float sink2, const bf16* sgarow, bf16* orow, int lane) {
    const int q = lane & 31, h = lane >> 5;
    bf16x8 qf[4];
#pragma unroll
    for (int s = 0; s < 4; ++s) qf[s] = *(const GAS bf16x8*)(qrow + 16 * s + 8 * h);
    f32x16 S[6];
#pragma unroll
    for (int kt = 0; kt < 6; ++kt) {
        if (kt < nkt) {
            f32x16 a;
#pragma unroll
            for (int r = 0; r < 16; ++r) a[r] = 0.f;
            const int key = 32 * kt + q;
#pragma unroll
            for (int s = 0; s < 4; ++s) { const bf16x8 kf = *(const LAS bf16x8*)(kimg + key * 128 + (((2 * s + h) ^ ((key >> 1) & 7)) << 4)); a = __builtin_amdgcn_mfma_f32_32x32x16_bf16(kf, qf[s], a, 0, 0, 0); }
            S[kt] = a;
        }
    }
    float mx = sink2;
#pragma unroll
    for (int kt = 0; kt < 6; ++kt) if (kt < nkt) {
#pragma unroll
        for (int r = 0; r < 16; ++r) mx = fmaxf(mx, S[kt][r]); }
    mx = fmaxf(mx, __shfl_xor(mx, 32));
    float sum = 0.f;
#pragma unroll
    for (int kt = 0; kt < 6; ++kt) if (kt < nkt) {
#pragma unroll
        for (int r = 0; r < 16; ++r) { const float e = __builtin_amdgcn_exp2f(S[kt][r] - mx); S[kt][r] = e; sum += e; } }
    sum += __shfl_xor(sum, 32);
    sum += __builtin_amdgcn_exp2f(sink2 - mx);
    const float inv = 1.0f / sum;
    f32x16 O0, O1;
#pragma unroll
    for (int r = 0; r < 16; ++r) { O0[r] = 0.f; O1[r] = 0.f; }
#pragma unroll
    for (int kt = 0; kt < 6; ++kt) if (kt < nkt) {
#pragma unroll
        for (int s2 = 0; s2 < 2; ++s2) {
            v4u pw; pw.x = cvtpk(S[kt][8 * s2 + 0], S[kt][8 * s2 + 1]); pw.y = cvtpk(S[kt][8 * s2 + 2], S[kt][8 * s2 + 3]); pw.z = cvtpk(S[kt][8 * s2 + 4], S[kt][8 * s2 + 5]); pw.w = cvtpk(S[kt][8 * s2 + 6], S[kt][8 * s2 + 7]);
            const bf16x8 pf = __builtin_bit_cast(bf16x8, pw);
            const int kb2 = (32 * kt + 16 * s2 + 4 * h) * 2;
            { const v2u lo = *(const LAS v2u*)(vtimg + q * VT_PITCH + kb2), hi = *(const LAS v2u*)(vtimg + q * VT_PITCH + kb2 + 16);
              const bf16x8 vf = __builtin_bit_cast(bf16x8, (v4u){lo.x, lo.y, hi.x, hi.y}); O0 = __builtin_amdgcn_mfma_f32_32x32x16_bf16(vf, pf, O0, 0, 0, 0); }
            { const v2u lo = *(const LAS v2u*)(vtimg + (32 + q) * VT_PITCH + kb2), hi = *(const LAS v2u*)(vtimg + (32 + q) * VT_PITCH + kb2 + 16);
              const bf16x8 vf = __builtin_bit_cast(bf16x8, (v4u){lo.x, lo.y, hi.x, hi.y}); O1 = __builtin_amdgcn_mfma_f32_32x32x16_bf16(vf, pf, O1, 0, 0, 0); }
        } }
#pragma unroll
    for (int g4 = 0; g4 < 4; ++g4) {
        { const int d0 = 8 * g4 + 4 * h; const v2u gw_ = *(const GAS v2u*)(sgarow + d0);
          v2u o; o.x = cvtpk(O0[4 * g4 + 0] * inv * bflo(gw_.x), O0[4 * g4 + 1] * inv * bfhi(gw_.x)); o.y = cvtpk(O0[4 * g4 + 2] * inv * bflo(gw_.y), O0[4 * g4 + 3] * inv * bfhi(gw_.y)); *(GAS v2u*)(orow + d0) = o; }
        { const int d0 = 32 + 8 * g4 + 4 * h; const v2u gw_ = *(const GAS v2u*)(sgarow + d0);
          v2u o; o.x = cvtpk(O1[4 * g4 + 0] * inv * bflo(gw_.x), O1[4 * g4 + 1] * inv * bfhi(gw_.x)); o.y = cvtpk(O1[4 * g4 + 2] * inv * bflo(gw_.y), O1[4 * g4 + 3] * inv * bfhi(gw_.y)); *(GAS v2u*)(orow + d0) = o; }
    }
}
__device__ __forceinline__ void vt_scatter(LAS unsigned char* vt, int drow0, int key, const v4u& w) {
    LAS unsigned short* p = (LAS unsigned short*)(vt + drow0 * VT_PITCH + key * 2);
    p[0 * (VT_PITCH / 2)] = (unsigned short)(w.x & 0xffffu); p[1 * (VT_PITCH / 2)] = (unsigned short)(w.x >> 16); p[2 * (VT_PITCH / 2)] = (unsigned short)(w.y & 0xffffu); p[3 * (VT_PITCH / 2)] = (unsigned short)(w.y >> 16);
    p[4 * (VT_PITCH / 2)] = (unsigned short)(w.z & 0xffffu); p[5 * (VT_PITCH / 2)] = (unsigned short)(w.z >> 16); p[6 * (VT_PITCH / 2)] = (unsigned short)(w.w & 0xffffu); p[7 * (VT_PITCH / 2)] = (unsigned short)(w.w >> 16);
}
__device__ __forceinline__ v4u cvt8(const float* p) { const f32x4 a = *(const GAS f32x4*)p, b = *(const GAS f32x4*)(p + 4); v4u w; w.x = pk2(a.x, a.y); w.y = pk2(a.z, a.w); w.z = pk2(b.x, b.y); w.w = pk2(b.z, b.w); return w; }

__device__ __forceinline__ void p2_phase(const Args& A, LAS unsigned char* lds, int G, int tid, int wave, int lane) {
    unsigned char* ws = A.ws;
    const bf16* Q = (const bf16*)(ws + WS_Q); const bf16* KV = (const bf16*)(ws + WS_KV); const bf16* SGA = (const bf16*)(ws + WS_SGA);
    const bf16* U = (const bf16*)(ws + WS_U); const bf16* BG = (const bf16*)(ws + WS_BG); bf16* AB1 = (bf16*)(ws + WS_AB1);
    LAS unsigned char* kimg = lds + ATT_K_OFF; LAS unsigned char* vt = lds + ATT_VT_OFF;
    constexpr int NU_P = 512, NU_S = NSEQ, NU_C = MTOT / 64, NU = NU_P + NU_S + NU_C;
    for (int it = blockIdx.x; it < NU; it += G) {
        if (it < NU_P) {
            const int c = it >> 1, v = it & 1, kc0 = c >= 2 ? c - 2 : 0, nkeys = (c - kc0 + 1) * 64, krow0 = kc0 * 64;
            __syncthreads();
            for (int p = tid; p < nkeys * 8; p += 512) { const int key = p >> 3, ch = p & 7;
                const v4u d = *(const GAS v4u*)(KV + (size_t)(krow0 + key) * 256 + v * 64 + ch * 8);
                *(LAS v4u*)(kimg + key * 128 + ((ch ^ ((key >> 1) & 7)) << 4)) = d; }
            for (int p = tid; p < nkeys * 8; p += 512) { const int ch = p / nkeys, key = p - ch * nkeys;
                const v4u d = *(const GAS v4u*)(KV + (size_t)(krow0 + key) * 256 + 128 + v * 64 + ch * 8);
                vt_scatter(vt, ch * 8, key, d); }
            __syncthreads();
            const int head = 4 * v + (wave >> 1), mrow = 64 * c + 32 * (wave & 1) + (lane & 31);
            attn_wave(kimg, vt, nkeys >> 5, Q + (size_t)mrow * 512 + head * 64, A.in[I_SINK][head] * 1.4426950408889634f, SGA + (size_t)mrow * 512 + head * 64, AB1 + (size_t)mrow * 1024 + head * 64, lane);
        } else if (it < NU_P + NU_S) {
            const int b = it - NU_P;
            __syncthreads();
            for (int p = tid; p < 2 * 160 * 8; p += 512) { const int ch = p & 7, rk = p >> 3, v = rk >= 160, key = rk - 160 * v;
                v4u d;
                if (key < 128) d = cvt8(A.in[I_CK] + ((size_t)(b * 128 + key) * 2 + v) * 64 + ch * 8);
                else d = *(const GAS v4u*)(KV + (size_t)(TP + 32 * b + key - 128) * 256 + v * 64 + ch * 8);
                *(LAS v4u*)(kimg + rk * 128 + ((ch ^ ((rk >> 1) & 7)) << 4)) = d; }
            for (int p = tid; p < 2 * 160 * 8; p += 512) { const int v = p >= 1280, r = p - 1280 * v, ch = r / 160, key = r - ch * 160;
                v4u d;
                if (key < 128) d = cvt8(A.in[I_CV] + ((size_t)(b * 128 + key) * 2 + v) * 64 + ch * 8);
                else d = *(const GAS v4u*)(KV + (size_t)(TP + 32 * b + key - 128) * 256 + 128 + v * 64 + ch * 8);
                vt_scatter(vt, v * 64 + ch * 8, key, d); }
            __syncthreads();
            const int v = wave >> 2, head = wave, mrow = TP + 32 * b + (lane & 31);
            attn_wave(kimg + v * 160 * 128, vt + v * 64 * VT_PITCH, 5, Q + (size_t)mrow * 512 + head * 64, A.in[I_SINK][head] * 1.4426950408889634f, SGA + (size_t)mrow * 512 + head * 64, AB1 + (size_t)mrow * 1024 + head * 64, lane);
        } else {
            const int r0 = (it - NU_P - NU_S) * 64;
            for (int p = tid; p < 64 * 64; p += 512) { const int m = r0 + (p >> 6), j0 = (p & 63) * 8;
                const float* cw = A.in[I_CW] + j0;
                f32x4 w0a = *(const GAS f32x4*)(cw), w0b = *(const GAS f32x4*)(cw + 4), w1a = *(const GAS f32x4*)(cw + 512), w1b = *(const GAS f32x4*)(cw + 516), w2a = *(const GAS f32x4*)(cw + 1024), w2b = *(const GAS f32x4*)(cw + 1028);
                f32x4 ua, ub, acca, accb;
                pg8::unpack8(*(const GAS v4u*)(U + (size_t)m * 512 + j0), ua, ub); acca = ua * w2a; accb = ub * w2b;
                const int t = m < TP ? m : (m & 31);
                if (t >= 1) { pg8::unpack8(*(const GAS v4u*)(U + (size_t)(m - 1) * 512 + j0), ua, ub); acca += ua * w1a; accb += ub * w1b; }
                else if (m >= TP) { const float* sc = A.in[I_SC] + ((size_t)((m - TP) >> 5) * 2 + 1) * 512 + j0; acca += *(const GAS f32x4*)(sc) * w1a; accb += *(const GAS f32x4*)(sc + 4) * w1b; }
                if (t >= 2) { pg8::unpack8(*(const GAS v4u*)(U + (size_t)(m - 2) * 512 + j0), ua, ub); acca += ua * w0a; accb += ub * w0b; }
                else if (m >= TP) { const float* sc = A.in[I_SC] + ((size_t)((m - TP) >> 5) * 2 + t) * 512 + j0; acca += *(const GAS f32x4*)(sc) * w0a; accb += *(const GAS f32x4*)(sc + 4) * w0b; }
                f32x4 ga, gb; pg8::unpack8(*(const GAS v4u*)(BG + (size_t)m * 512 + j0), ga, gb);
                *(GAS v4u*)(AB1 + (size_t)m * 1024 + 512 + j0) = pg8::pack8(acca * ga, accb * gb); }
        }
    }
    __syncthreads();
}

__global__ void __launch_bounds__(NWAVES * 64, 2) hybrid_fwd(Args args) {
    extern __shared__ __attribute__((aligned(16))) unsigned char lds_raw[];
    LAS unsigned char* lds = (LAS unsigned char*)lds_raw;
    volatile LAS unsigned* MISC = (volatile LAS unsigned*)(lds + MISC_OFF);
    const int tid = threadIdx.x, lane = tid & 63, wave = __builtin_amdgcn_readfirstlane(tid >> 6);
    const int G = gridDim.x; const int bx = blockIdx.x; const int vcu = (G % 8 == 0) ? (bx % 8) * (G / 8) + bx / 8 : bx;
    unsigned char* ws = args.ws;
    gu32* ctl = (gu32*)(ws + WS_CTL);
    for (int u = tid; u < (LDS_BYTES - LDSCTL_OFF) / 4; u += NWAVES * 64) ((LAS unsigned*)(lds + LDSCTL_OFF))[u] = 0u;
    __syncthreads();
    XcdBarrier bar; bar.bar = (unsigned*)(ctl + CW_BAR); bar.x = 0; bar.st = nullptr;
    if (N_LAUNCHES != PER_PHASE) bar = xcd_barrier_post((unsigned*)(ctl + CW_BAR), MISC + 8);
#define GRID_BAR() do { if (N_LAUNCHES != PER_PHASE) xcd_barrier(bar); } while (0)
    const int lo = args.ph_lo, hi = args.ph_hi;
#ifndef PH_MASK
#define PH_MASK 63
#endif
#define IN(k) (((PH_MASK >> (k)) & 1) && lo <= (k) && (k) < hi)
#define BOTH(k) (IN(k) && IN((k) + 1))
    bf16* XN = (bf16*)(ws + WS_XN); bf16* PB = (bf16*)(ws + WS_PB);

    if (IN(0)) { p0_prologue(args, lds, vcu * NWAVES + wave, G * NWAVES, wave, lane); if (BOTH(0)) GRID_BAR(); }

    if (IN(1)) {
        { pg8::Gemm g{XN, (const bf16*)(ws + WS_WIN), MTOT, NZ, DM}; pg8::StaticOrder S; S.init(MTOT, NZ, G, bx);
          pg8::EpiZ E{ws, (bf16*)(ws + WS_Q), (bf16*)(ws + WS_KV), (bf16*)(ws + WS_U), (bf16*)(ws + WS_BG),
                      (const float*)(ws + WS_ROPE), args.in[I_QG], args.in[I_KG], args.out};
          pg8::gemm_phase<pg8::EpiZ, pg8::StaticOrder, PG8_ALIGN, PG8_SP2>(lds + RING_OFF, g, S, E); }
        { pg8::Gemm g{PB, (const bf16*)(ws + WS_WPP), MTOT, DM, PLE}; pg8::StaticOrder S; S.init(MTOT, DM, G, (bx + 104) % G);
          pg8::EpiStore E{(bf16*)(ws + WS_PP), DM};
          pg8::gemm_phase<pg8::EpiStore, pg8::StaticOrder, PG8_ALIGN, PG8_SP2>(lds + RING_OFF, g, S, E); }
        if (BOTH(1)) GRID_BAR();
    }
    if (IN(2)) { p2_phase(args, lds, G, tid, wave, lane); if (BOTH(2)) GRID_BAR(); }
    if (IN(3)) {
        pg8::Gemm g{(const bf16*)(ws + WS_AB1), (const bf16*)(ws + WS_WAB), MTOT, DM, DM}; pg8::StaticOrder S; S.init(MTOT, DM, G, bx);
        pg8::EpiMerge E{(const bf16*)(ws + WS_SMA), (const bf16*)(ws + WS_SMB), (bf16*)(ws + WS_MM)};
        pg8::gemm_phase<pg8::EpiMerge, pg8::StaticOrder, PG8_ALIGN, PG8_SP2>(lds + RING_OFF, g, S, E);
        if (BOTH(3)) GRID_BAR();
    }
    if (IN(4)) {
        pg8::Gemm g{(const bf16*)(ws + WS_MM), (const bf16*)(ws + WS_WO), MTOT, DM, DM}; pg8::StaticOrder S; S.init(MTOT, DM, G, bx);
        pg8::EpiResid E{args.in[I_XP], args.in[I_XS], args.out, (bf16*)(ws + WS_RB)};
        pg8::gemm_phase<pg8::EpiResid, pg8::StaticOrder, PG8_ALIGN, PG8_SP2>(lds + RING_OFF, g, S, E);
        if (BOTH(4)) GRID_BAR();
    }
    if (IN(5)) {
        pg8::Gemm g{(const bf16*)(ws + WS_RB), (const bf16*)(ws + WS_WPG), MTOT, DM, DM}; pg8::StaticOrder S; S.init(MTOT, DM, G, bx);
        pg8::EpiOut E{args.out, (const bf16*)(ws + WS_PP)};
        pg8::gemm_phase<pg8::EpiOut, pg8::StaticOrder, PG8_ALIGN, PG8_SP2>(lds + RING_OFF, g, S, E);
    }
#undef IN
#undef BOTH
}

extern "C" void kernel_launch(void* const* d_in, const int* in_sizes, int n_in, void* d_out, int out_size, void* d_ws, size_t ws_size, hipStream_t stream) {
    static int grid = 0;
    if (grid == 0) {
        if (n_in != 18 || in_sizes[0] != TP * DM || (size_t)out_size != pg8::OUT_TOTAL || ws_size < WS_END) { fprintf(stderr, "kernel_launch: shape mismatch (n_in %d, in0 %d, out %d, ws %zu); nothing launched\n", n_in, n_in > 0 ? in_sizes[0] : -1, out_size, ws_size); grid = -1; return; }
        int dev = 0, cus = 0, per_cu = 0;
        if (hipGetDevice(&dev) != hipSuccess || hipDeviceGetAttribute(&cus, hipDeviceAttributeMultiprocessorCount, dev) != hipSuccess) { fprintf(stderr, "kernel_launch: hipGetDevice / hipDeviceGetAttribute failed\n"); grid = -1; return; }
        if (hipFuncSetAttribute((const void*)hybrid_fwd, hipFuncAttributeMaxDynamicSharedMemorySize, LDS_BYTES) != hipSuccess) { fprintf(stderr, "kernel_launch: hipFuncSetAttribute failed\n"); grid = -1; return; }
        if (hipOccupancyMaxActiveBlocksPerMultiprocessor(&per_cu, (const void*)hybrid_fwd, NWAVES * 64, LDS_BYTES) != hipSuccess || per_cu < 1)
            fprintf(stderr, "kernel_launch: note: the occupancy query reports %d workgroups per CU\n", per_cu);
        (void)hipGetLastError();
        grid = cus;
    }
    if (grid < 0) return;
    if (hipMemsetAsync((char*)d_ws + WS_CTL, 0, CTL_ZERO_BYTES, stream) != hipSuccess) { fprintf(stderr, "kernel_launch: hipMemsetAsync failed\n"); return; }
    Args a{};
    for (int i = 0; i < 18; ++i) a.in[i] = (const float*)d_in[i];
    a.out = (float*)d_out; a.ws = (unsigned char*)d_ws;
    for (int li = 0; li < N_LAUNCHES; ++li) {
        a.ph_lo = (N_LAUNCHES == PER_PHASE) ? li : 0; a.ph_hi = (N_LAUNCHES == PER_PHASE) ? li + 1 : PER_PHASE; a.li = li;
        hipLaunchKernelGGL(hybrid_fwd, dim3(grid), dim3(NWAVES * 64), LDS_BYTES, stream, a);
        const hipError_t le = hipPeekAtLastError();
        if (le != hipSuccess) { fprintf(stderr, "kernel_launch: launch %d failed: %s\n", li, hipGetErrorName(le)); break; }
    }
}
```
